# Optimizing an MI355X kernel written in HIP

```python
import jax, jax.numpy as jnp
from jax import lax
import numpy as np


D_MODEL = 2048
BATCH = 2
SEQ = 4096
DEPTH = 2

D_A = D_MODEL // 2
A_HEAD = 128
A_HEADS = D_A // A_HEAD
A_CHUNK = 128
D_B = D_MODEL // 2
B_GROUPS = 4
B_GROUP = D_B // B_GROUPS
B_WINDOWS = (2, 4, 8, 16)
D_C = D_MODEL
C_HEAD = 128
C_HEADS = D_C // C_HEAD
C_CHUNK = 64
D_FF = 5632
CONV_W = 3
N_EVEN = (DEPTH + 1) // 2
N_ODD = DEPTH // 2
ALPHA = (2 * DEPTH) ** 0.25
BETA = (8 * DEPTH) ** -0.25
LN_EPS = 1e-5

kernel_name = 'hybrid_gmlp_pool_hgrn2_convffn_deepnorm'


def layer_norm(x, g, b):
    xf = x.astype(jnp.float32)
    mu = jnp.mean(xf, axis=-1, keepdims=True)
    var = jnp.mean(jnp.square(xf - mu), axis=-1, keepdims=True)
    return ((xf - mu) * lax.rsqrt(var + LN_EPS) * g + b).astype(x.dtype)


def rms_norm(x, g):
    xf = x.astype(jnp.float32)
    return xf * lax.rsqrt(jnp.mean(jnp.square(xf), axis=-1, keepdims=True) + LN_EPS) * g


def shift_right(x, s):
    pad = [(0, 0)] * x.ndim
    pad[1] = (s, 0)
    return jnp.pad(x, pad)[:, :x.shape[1]]


def spatial_gating(za, ln_g, ln_b, w_s, b_s):
    bn, t, _ = za.shape
    u, v = jnp.split(za, 2, axis=-1)
    v = layer_norm(v, ln_g, ln_b)
    v = v.reshape(bn, t // A_CHUNK, A_CHUNK, A_HEADS, A_HEAD)
    w = jnp.tril(w_s)
    s = jnp.einsum('hts,bnshc->bnthc', w, v) + b_s.T[None, None, :, :, None]
    return u * s.reshape(bn, t, D_A)


def multiscale_pool(xb, w_pool, scale):
    bn, t, _ = xb.shape
    xg = xb.reshape(bn, t, B_GROUPS, B_GROUP).astype(jnp.float32)
    csum = jnp.cumsum(xg, axis=1)
    pos = jnp.arange(1, t + 1, dtype=jnp.float32)
    outs = []
    for gi, win in enumerate(B_WINDOWS):
        c = csum[:, :, gi]
        wsum = c - shift_right(c, win)
        cnt = jnp.minimum(pos, float(win))[None, :, None]
        outs.append(wsum / cnt - xg[:, :, gi])
    p = jnp.stack(outs, axis=2).astype(xb.dtype)
    y = jnp.einsum('btgc,gcd->btgd', p, w_pool)
    return y.reshape(bn, t, D_B) * scale


def hgrn2(q, f_logit, inp, lb):
    bn, t, _ = q.shape
    n = t // C_CHUNK
    f32 = jnp.float32

    def heads(a):
        return a.astype(f32).reshape(bn, n, C_CHUNK, C_HEADS, C_HEAD).transpose(0, 3, 1, 2, 4)

    f = lb + (1.0 - lb) * jax.nn.sigmoid(f_logit.astype(f32))
    qh = heads(jax.nn.silu(q.astype(f32)))
    kh = heads(1.0 - f)
    vh = heads(inp)
    bcum = jnp.cumsum(heads(jnp.log(f)), axis=3)
    blast = bcum[:, :, :, -1:, :]
    q_dec = qh * jnp.exp(bcum)
    k_dec = kh * jnp.exp(-bcum)
    k_end = kh * jnp.exp(blast - bcum)
    mask = jnp.tril(jnp.ones((C_CHUNK, C_CHUNK), dtype=bool))
    att = jnp.where(mask, jnp.einsum('bhntd,bhnsd->bhnts', q_dec, k_dec), 0.0)
    o_intra = jnp.einsum('bhnts,bhnse->bhnte', att, vh)
    upd = jnp.einsum('bhnsd,bhnse->bhnde', k_end, vh)
    dec = jnp.exp(blast[:, :, :, 0, :])

    def step(state, xs):
        d_n, u_n = xs
        return d_n[..., None] * state + u_n, state

    s0 = jnp.zeros((bn, C_HEADS, C_HEAD, C_HEAD), f32)
    _, s_prev = lax.scan(step, s0, (jnp.moveaxis(dec, 2, 0), jnp.moveaxis(upd, 2, 0)))
    s_prev = jnp.moveaxis(s_prev, 0, 2)
    o = o_intra + jnp.einsum('bhntd,bhnde->bhnte', q_dec, s_prev)
    return o.transpose(0, 2, 3, 1, 4).reshape(bn, t, C_HEADS, C_HEAD)


def conv_ffn(x, w_up, conv_w, conv_b, w_down):
    h = x @ w_up
    hc = conv_b + conv_w[CONV_W - 1] * h
    for j in range(CONV_W - 1):
        hc = hc + conv_w[j] * shift_right(h, CONV_W - 1 - j)
    a, v = jnp.split(hc, 2, axis=-1)
    return (jax.nn.silu(a) * v) @ w_down


def setup_inputs(seed: int = 0) -> dict:
    key = jax.random.key(seed)
    ks = jax.random.split(key, 24)
    f32 = jnp.float32

    def nrm(k, shape, scale):
        return jax.random.normal(k, shape, f32) * scale

    return {
        'x': nrm(ks[0], (BATCH, SEQ, D_MODEL), 1.0),
        'ev_w_in': nrm(ks[1], (N_EVEN, D_MODEL, 2 * D_A + D_B), D_MODEL ** -0.5),
        'ev_ln_v_g': 1.0 + nrm(ks[2], (N_EVEN, D_A), 0.02),
        'ev_ln_v_b': nrm(ks[3], (N_EVEN, D_A), 0.02),
        'ev_w_s': nrm(ks[4], (N_EVEN, A_HEADS, A_CHUNK, A_CHUNK), 0.5 * A_CHUNK ** -0.5),
        'ev_b_s': 1.0 + nrm(ks[5], (N_EVEN, A_HEADS, A_CHUNK), 0.02),
        'ev_w_pool': nrm(ks[6], (N_EVEN, B_GROUPS, B_GROUP, B_GROUP), B_GROUP ** -0.5),
        'ev_pool_scale': 1.0 + nrm(ks[7], (N_EVEN, D_B), 0.02),
        'ev_w_out': nrm(ks[8], (N_EVEN, D_A + D_B, D_MODEL), BETA * (D_A + D_B) ** -0.5),
        'od_w_in': nrm(ks[9], (N_ODD, D_MODEL, 4 * D_C), D_MODEL ** -0.5),
        'od_norm_g': 1.0 + nrm(ks[10], (N_ODD, D_C), 0.02),
        'od_w_out': nrm(ks[11], (N_ODD, D_C, D_MODEL), BETA * D_C ** -0.5),
        'lb_param': nrm(ks[12], (DEPTH, D_C), 0.1),
        'ffn_w_up': nrm(ks[13], (DEPTH, D_MODEL, 2 * D_FF), D_MODEL ** -0.5),
        'ffn_conv_w': nrm(ks[14], (DEPTH, CONV_W, 2 * D_FF), CONV_W ** -0.5),
        'ffn_conv_b': nrm(ks[15], (DEPTH, 2 * D_FF), 0.02),
        'ffn_w_down': nrm(ks[16], (DEPTH, D_FF, D_MODEL), BETA * D_FF ** -0.5),
        'ln1_g': 1.0 + nrm(ks[17], (DEPTH, D_MODEL), 0.02),
        'ln1_b': nrm(ks[18], (DEPTH, D_MODEL), 0.02),
        'ln2_g': 1.0 + nrm(ks[19], (DEPTH, D_MODEL), 0.02),
        'ln2_b': nrm(ks[20], (DEPTH, D_MODEL), 0.02),
    }


def reference(x, ev_w_in, ev_ln_v_g, ev_ln_v_b, ev_w_s, ev_b_s, ev_w_pool, ev_pool_scale,
              ev_w_out, od_w_in, od_norm_g, od_w_out, lb_param, ffn_w_up, ffn_conv_w,
              ffn_conv_b, ffn_w_down, ln1_g, ln1_b, ln2_g, ln2_b):
    bn, t, _ = x.shape
    lb_all = jnp.cumsum(jax.nn.softmax(lb_param.astype(jnp.float32), axis=0), axis=0)
    lb_all = lb_all - lb_all[0]
    for l in range(DEPTH):
        if l % 2 == 0:
            e = l // 2
            h = x @ ev_w_in[e]
            za = jax.nn.gelu(h[..., :2 * D_A])
            xb = h[..., 2 * D_A:]
            ya = spatial_gating(za, ev_ln_v_g[e], ev_ln_v_b[e], ev_w_s[e], ev_b_s[e])
            yb = multiscale_pool(xb, ev_w_pool[e], ev_pool_scale[e])
            mix = jnp.concatenate([ya, yb], axis=-1) @ ev_w_out[e]
        else:
            o = l // 2
            h = x @ od_w_in[o]
            q, f_logit, inp, g = jnp.split(h, 4, axis=-1)
            y = hgrn2(q, f_logit, inp, lb_all[l])
            y = rms_norm(y, od_norm_g[o].reshape(C_HEADS, C_HEAD)).reshape(bn, t, D_C)
            y = (y * jax.nn.sigmoid(g.astype(jnp.float32))).astype(x.dtype)
            mix = y @ od_w_out[o]
        x = layer_norm(ALPHA * x + mix, ln1_g[l], ln1_b[l])
        x = layer_norm(ALPHA * x + conv_ffn(x, ffn_w_up[l], ffn_conv_w[l], ffn_conv_b[l], ffn_w_down[l]),
                       ln2_g[l], ln2_b[l])
    return x
```

```cpp
#include <hip/hip_runtime.h>
#include <cstdio>
#include <cstdint>

namespace nv {
constexpr int D = 2048, BATCH = 2, T = 4096, M = BATCH * T;
constexpr int DA = 1024, DB = 1024, NIN0 = 3072, DC = 2048, NIN1 = 8192, DFF = 5632, NUP = 2 * DFF;
constexpr float ALPHA = 1.41421356237f, EPS = 1e-5f;

__global__ __launch_bounds__(256) void sgemm(const float* __restrict__ A, const float* __restrict__ B, float* __restrict__ C, int Mm, int N, int K) {
    __shared__ float As[16][132];
    __shared__ float Bs[16][132];
    const int tid = threadIdx.x, tx = tid & 15, ty = tid >> 4;
    const int bm = blockIdx.y * 128, bn = blockIdx.x * 128;
    float acc[8][8];
#pragma unroll
    for (int i = 0; i < 8; ++i)
#pragma unroll
        for (int j = 0; j < 8; ++j) acc[i][j] = 0.f;
    const int ar = tid >> 1, ac = (tid & 1) * 8;
    const int br = tid >> 4, bc = (tid & 15) * 8;
    for (int k0 = 0; k0 < K; k0 += 16) {
        const float4 a0 = *(const float4*)(A + (size_t)(bm + ar) * K + k0 + ac);
        const float4 a1 = *(const float4*)(A + (size_t)(bm + ar) * K + k0 + ac + 4);
        const float4 b0 = *(const float4*)(B + (size_t)(k0 + br) * N + bn + bc);
        const float4 b1 = *(const float4*)(B + (size_t)(k0 + br) * N + bn + bc + 4);
        __syncthreads();
        As[ac + 0][ar] = a0.x; As[ac + 1][ar] = a0.y; As[ac + 2][ar] = a0.z; As[ac + 3][ar] = a0.w;
        As[ac + 4][ar] = a1.x; As[ac + 5][ar] = a1.y; As[ac + 6][ar] = a1.z; As[ac + 7][ar] = a1.w;
        *(float4*)&Bs[br][bc] = b0; *(float4*)&Bs[br][bc + 4] = b1;
        __syncthreads();
#pragma unroll
        for (int kk = 0; kk < 16; ++kk) {
            float a[8], b[8];
#pragma unroll
            for (int i = 0; i < 8; ++i) a[i] = As[kk][ty * 8 + i];
#pragma unroll
            for (int j = 0; j < 8; ++j) b[j] = Bs[kk][tx * 8 + j];
#pragma unroll
            for (int i = 0; i < 8; ++i)
#pragma unroll
                for (int j = 0; j < 8; ++j) acc[i][j] = fmaf(a[i], b[j], acc[i][j]);
        }
    }
#pragma unroll
    for (int i = 0; i < 8; ++i) {
        float* cp = C + (size_t)(bm + ty * 8 + i) * N + bn + tx * 8;
        *(float4*)cp = make_float4(acc[i][0], acc[i][1], acc[i][2], acc[i][3]);
        *(float4*)(cp + 4) = make_float4(acc[i][4], acc[i][5], acc[i][6], acc[i][7]);
    }
}

__device__ __forceinline__ float gelu_tanh(float x) { const float u = 0.7978845608028654f * (x + 0.044715f * x * x * x); return 0.5f * x * (1.f + tanhf(u)); }
__device__ __forceinline__ float sigmoidf(float x) { return 1.f / (1.f + expf(-x)); }
__device__ __forceinline__ float wave_sum(float v) {
#pragma unroll
    for (int o = 1; o < 64; o <<= 1) v += __shfl_xor(v, o);
    return v;
}

__global__ __launch_bounds__(256) void k_gelu_ln(const float* __restrict__ H, const float* __restrict__ g, const float* __restrict__ b, float* __restrict__ U, float* __restrict__ VLN) {
    const int row = blockIdx.x * 4 + (threadIdx.x >> 6), lane = threadIdx.x & 63;
    const float* h = H + (size_t)row * NIN0;
    float v[16]; float s = 0.f;
#pragma unroll
    for (int j = 0; j < 16; ++j) { U[(size_t)row * DA + lane + 64 * j] = gelu_tanh(h[lane + 64 * j]); v[j] = gelu_tanh(h[DA + lane + 64 * j]); s += v[j]; }
    const float mean = wave_sum(s) * (1.f / DA); float q = 0.f;
#pragma unroll
    for (int j = 0; j < 16; ++j) { v[j] -= mean; q += v[j] * v[j]; }
    const float rstd = rsqrtf(wave_sum(q) * (1.f / DA) + EPS);
#pragma unroll
    for (int j = 0; j < 16; ++j) { const int c = lane + 64 * j; VLN[(size_t)row * DA + c] = v[j] * rstd * g[c] + b[c]; }
}
__global__ __launch_bounds__(256) void k_spatial(const float* __restrict__ U, const float* __restrict__ VLN, const float* __restrict__ W, const float* __restrict__ bs, float* __restrict__ CAT) {
    const int idx = blockIdx.x * 256 + threadIdx.x;
    const int row = idx >> 10, ch = idx & 1023, h = ch >> 7, t = row & 127, r0 = row - t;
    const float* w = W + ((size_t)h * 128 + t) * 128;
    float s = 0.f;
    for (int ss = 0; ss <= t; ++ss) s = fmaf(w[ss], VLN[(size_t)(r0 + ss) * DA + ch], s);
    s += bs[h * 128 + t];
    CAT[(size_t)row * D + ch] = U[(size_t)row * DA + ch] * s;
}
__global__ __launch_bounds__(256) void k_pool(const float* __restrict__ H, float* __restrict__ P) {
    const int idx = blockIdx.x * 256 + threadIdx.x;
    const int row = idx >> 10, ch = idx & 1023, g = ch >> 8, t = row & (T - 1);
    const int win = 2 << g;
    const int n = (t + 1 < win) ? t + 1 : win;
    float s = 0.f;
    for (int j = 0; j < n; ++j) s += H[(size_t)(row - j) * NIN0 + 2 * DA + ch];
    P[(size_t)row * DB + ch] = s / (float)n - H[(size_t)row * NIN0 + 2 * DA + ch];
}
__global__ __launch_bounds__(256) void k_poolmm(const float* __restrict__ P, const float* __restrict__ WP, const float* __restrict__ scale, float* __restrict__ CAT) {
    const int idx = blockIdx.x * 256 + threadIdx.x;
    const int row = idx >> 10, ch = idx & 1023, g = ch >> 8, d = ch & 255;
    const float* p = P + (size_t)row * DB + g * 256; const float* w = WP + (size_t)g * 65536 + d;
    float s = 0.f;
    for (int c = 0; c < 256; ++c) s = fmaf(p[c], w[(size_t)c * 256], s);
    CAT[(size_t)row * D + DA + ch] = s * scale[ch];
}
__global__ __launch_bounds__(256) void k_res_ln(const float* __restrict__ xin, const float* __restrict__ mix, const float* __restrict__ g, const float* __restrict__ b, float* __restrict__ xout) {
    const int row = blockIdx.x * 4 + (threadIdx.x >> 6), lane = threadIdx.x & 63;
    float v[32]; float s = 0.f;
#pragma unroll
    for (int j = 0; j < 32; ++j) { const size_t o = (size_t)row * D + lane + 64 * j; v[j] = ALPHA * xin[o] + mix[o]; s += v[j]; }
    const float mean = wave_sum(s) * (1.f / D); float q = 0.f;
#pragma unroll
    for (int j = 0; j < 32; ++j) { v[j] -= mean; q += v[j] * v[j]; }
    const float rstd = rsqrtf(wave_sum(q) * (1.f / D) + EPS);
#pragma unroll
    for (int j = 0; j < 32; ++j) { const int c = lane + 64 * j; xout[(size_t)row * D + c] = v[j] * rstd * g[c] + b[c]; }
}
__global__ __launch_bounds__(256) void k_conv_gate(const float* __restrict__ H, const float* __restrict__ cw, const float* __restrict__ cb, float* __restrict__ G) {
    const size_t idx = (size_t)blockIdx.x * 256 + threadIdx.x;
    const int row = (int)(idx / DFF), c = (int)(idx % DFF), t = row & (T - 1);
    float r[2];
#pragma unroll
    for (int p = 0; p < 2; ++p) {
        const int cc = c + p * DFF;
        float v = cb[cc] + cw[2 * NUP + cc] * H[(size_t)row * NUP + cc];
        if (t >= 1) v += cw[1 * NUP + cc] * H[(size_t)(row - 1) * NUP + cc];
        if (t >= 2) v += cw[0 * NUP + cc] * H[(size_t)(row - 2) * NUP + cc];
        r[p] = v;
    }
    G[idx] = r[0] * sigmoidf(r[0]) * r[1];
}
__global__ __launch_bounds__(256) void k_hgrn(const float* __restrict__ H, const float* __restrict__ lbp, float* __restrict__ O) {
    __shared__ float qs[128], fs[128], ks[128], vs[128], part[256];
    const int b = blockIdx.x >> 4, hd = blockIdx.x & 15, tid = threadIdx.x, e = tid & 127, dh = tid >> 7;
    float S[64];
#pragma unroll
    for (int i = 0; i < 64; ++i) S[i] = 0.f;
    float lb = 0.f;
    if (tid < 128) { const int c = hd * 128 + tid; const float p0 = lbp[c], p1 = lbp[DC + c]; const float m = fmaxf(p0, p1); const float e0 = expf(p0 - m), e1 = expf(p1 - m); lb = e1 / (e0 + e1); }
    for (int t = 0; t < T; ++t) {
        const float* h = H + (size_t)(b * T + t) * NIN1 + hd * 128;
        if (tid < 128) {
            const float q = h[tid], fl = h[DC + tid], in = h[2 * DC + tid];
            const float f = lb + (1.f - lb) * sigmoidf(fl);
            qs[tid] = q * sigmoidf(q); fs[tid] = f; ks[tid] = 1.f - f; vs[tid] = in;
        }
        __syncthreads();
        const float ve = vs[e]; float o = 0.f;
#pragma unroll
        for (int i = 0; i < 64; ++i) { const int d = dh * 64 + i; S[i] = fs[d] * S[i] + ks[d] * ve; o = fmaf(qs[d], S[i], o); }
        part[tid] = o;
        __syncthreads();
        if (tid < 128) O[(size_t)(b * T + t) * DC + hd * 128 + tid] = part[tid] + part[tid + 128];
    }
}
__global__ __launch_bounds__(256) void k_rms_gate(const float* __restrict__ O, const float* __restrict__ H, const float* __restrict__ gn, float* __restrict__ Y) {
    const int w = blockIdx.x * 4 + (threadIdx.x >> 6), lane = threadIdx.x & 63;
    const int row = w >> 4, hd = w & 15;
    const size_t o0 = (size_t)row * DC + hd * 128;
    const float a = O[o0 + lane], c = O[o0 + 64 + lane];
    const float r = rsqrtf(wave_sum(a * a + c * c) * (1.f / 128.f) + EPS);
    const float* g = H + (size_t)row * NIN1 + 3 * DC + hd * 128;
    Y[o0 + lane] = a * r * gn[hd * 128 + lane] * sigmoidf(g[lane]);
    Y[o0 + 64 + lane] = c * r * gn[hd * 128 + 64 + lane] * sigmoidf(g[64 + lane]);
}
}

extern "C" void kernel_launch(void* const* d_in, const int* in_sizes, int n_in, void* d_out, int out_size, void* d_ws, size_t ws_size, hipStream_t stream) {
    using namespace nv;
    const float* x = (const float*)d_in[0];
    const float* ev_w_in = (const float*)d_in[1]; const float* ev_ln_g = (const float*)d_in[2]; const float* ev_ln_b = (const float*)d_in[3];
    const float* ev_w_s = (const float*)d_in[4]; const float* ev_b_s = (const float*)d_in[5]; const float* ev_w_pool = (const float*)d_in[6];
    const float* ev_pool_scale = (const float*)d_in[7]; const float* ev_w_out = (const float*)d_in[8]; const float* od_w_in = (const float*)d_in[9];
    const float* od_norm_g = (const float*)d_in[10]; const float* od_w_out = (const float*)d_in[11]; const float* lb_param = (const float*)d_in[12];
    const float* ffn_w_up = (const float*)d_in[13]; const float* ffn_conv_w = (const float*)d_in[14]; const float* ffn_conv_b = (const float*)d_in[15];
    const float* ffn_w_down = (const float*)d_in[16]; const float* ln1_g = (const float*)d_in[17]; const float* ln1_b = (const float*)d_in[18];
    const float* ln2_g = (const float*)d_in[19]; const float* ln2_b = (const float*)d_in[20];
    float* out = (float*)d_out;
    char* ws = (char*)d_ws;
    float* X = (float*)ws;
    float* HB = (float*)(ws + (size_t)M * D * 4);
    float* GB = HB + (size_t)M * NUP;
    float* MIX = GB + (size_t)M * DFF;
    float* VLN = GB; float* P = GB + (size_t)M * DA; float* CAT = GB + (size_t)2 * M * DA; float* U = MIX;
    float* O = GB; float* Y = GB + (size_t)M * DC;

    auto gemm = [&](const float* A, const float* B, float* C, int N, int K) { hipLaunchKernelGGL(sgemm, dim3(N / 128, M / 128), dim3(256), 0, stream, A, B, C, M, N, K); };
    gemm(x, ev_w_in, HB, NIN0, D);
    hipLaunchKernelGGL(k_gelu_ln, dim3(M / 4), dim3(256), 0, stream, HB, ev_ln_g, ev_ln_b, U, VLN);
    hipLaunchKernelGGL(k_spatial, dim3(M * 1024 / 256), dim3(256), 0, stream, U, VLN, ev_w_s, ev_b_s, CAT);
    hipLaunchKernelGGL(k_pool, dim3(M * 1024 / 256), dim3(256), 0, stream, HB, P);
    hipLaunchKernelGGL(k_poolmm, dim3(M * 1024 / 256), dim3(256), 0, stream, P, ev_w_pool, ev_pool_scale, CAT);
    gemm(CAT, ev_w_out, MIX, D, D);
    hipLaunchKernelGGL(k_res_ln, dim3(M / 4), dim3(256), 0, stream, x, MIX, ln1_g, ln1_b, X);
    gemm(X, ffn_w_up, HB, NUP, D);
    hipLaunchKernelGGL(k_conv_gate, dim3((unsigned)((size_t)M * DFF / 256)), dim3(256), 0, stream, HB, ffn_conv_w, ffn_conv_b, GB);
    gemm(GB, ffn_w_down, MIX, D, DFF);
    hipLaunchKernelGGL(k_res_ln, dim3(M / 4), dim3(256), 0, stream, X, MIX, ln2_g, ln2_b, X);
    gemm(X, od_w_in, HB, NIN1, D);
    hipLaunchKernelGGL(k_hgrn, dim3(BATCH * 16), dim3(256), 0, stream, HB, lb_param, O);
    hipLaunchKernelGGL(k_rms_gate, dim3(M * 16 / 4), dim3(256), 0, stream, O, HB, od_norm_g, Y);
    gemm(Y, od_w_out, MIX, D, DC);
    hipLaunchKernelGGL(k_res_ln, dim3(M / 4), dim3(256), 0, stream, X, MIX, ln1_g + D, ln1_b + D, X);
    gemm(X, ffn_w_up + (size_t)D * NUP, HB, NUP, D);
    hipLaunchKernelGGL(k_conv_gate, dim3((unsigned)((size_t)M * DFF / 256)), dim3(256), 0, stream, HB, ffn_conv_w + 3 * NUP, ffn_conv_b + NUP, GB);
    gemm(GB, ffn_w_down + (size_t)DFF * D, MIX, D, DFF);
    hipLaunchKernelGGL(k_res_ln, dim3(M / 4), dim3(256), 0, stream, X, MIX, ln2_g + D, ln2_b + D, out);
}
```

```cpp
#include <hip/hip_runtime.h>
#include <cstdio>
#include <cstdint>

#define LAS __attribute__((address_space(3)))
#define GAS __attribute__((address_space(1)))
typedef unsigned short bf16_t;
typedef short bf16x8 __attribute__((ext_vector_type(8)));
typedef float f32x4 __attribute__((ext_vector_type(4)));
typedef float f32x2 __attribute__((ext_vector_type(2)));
typedef unsigned u32x4 __attribute__((ext_vector_type(4)));
typedef unsigned u32x2 __attribute__((ext_vector_type(2)));

#ifndef MK_N_LAUNCHES
#define MK_N_LAUNCHES 1
#endif

constexpr int D = 2048, BATCH = 2, T = 4096, M = BATCH * T;
constexpr int DA = 1024, DB = 1024, NIN0 = 3072, DC = 2048, NIN1 = 8192, DFF = 5632, NUP = 2 * DFF;
constexpr float ALPHA = 1.41421356237f, LN_EPS = 1e-5f;
constexpr int NWAVES = 8, NTHREADS = 512;

constexpr size_t MiB = 1u << 20;
constexpr size_t WS_CTL = 0, CTL_ZERO_BYTES = 1 * MiB;
constexpr size_t WS_WPOOL = 1 * MiB;
constexpr size_t WS_WIN0 = 2 * MiB;
constexpr size_t WS_WOUT0 = 14 * MiB;
constexpr size_t WS_WIN1 = 22 * MiB;
constexpr size_t WS_WOUT1 = 54 * MiB;
constexpr size_t WS_WUP = 62 * MiB;
constexpr size_t WS_WDOWN = 150 * MiB;
constexpr size_t WS_XF = 194 * MiB;
constexpr size_t WS_XN = 258 * MiB;
constexpr size_t WS_HB = 290 * MiB;
constexpr size_t WS_ZA = 290 * MiB;
constexpr size_t WS_XB = 322 * MiB;
constexpr size_t WS_PB = 338 * MiB;
constexpr size_t WS_CAT = 354 * MiB;
constexpr size_t WS_STAT = 386 * MiB;
constexpr size_t WS_QB = 290 * MiB;
constexpr size_t WS_FL = 322 * MiB;
constexpr size_t WS_VB = 386 * MiB;
constexpr size_t WS_SG = 418 * MiB;
static_assert(WS_FL == WS_QB + 32 * MiB && WS_VB == WS_QB + 96 * MiB && WS_SG == WS_QB + 128 * MiB, "EpiIn1 slot arithmetic");
constexpr size_t WS_GB = 466 * MiB;
constexpr size_t WS_UPD = 554 * MiB;
constexpr size_t WS_DEC = 618 * MiB;
constexpr size_t WS_YB = 619 * MiB;
constexpr size_t WS_END = 652 * MiB;

constexpr int RING_BYTES = 131072;
constexpr int LDS_BYTES = 147456;
constexpr int LDSCTL_OFF = LDS_BYTES - 256, MISC_OFF = LDSCTL_OFF;

typedef __bf16 nbf16x2 __attribute__((ext_vector_type(2)));
__device__ __forceinline__ unsigned cvt_pk_bf16(float lo, float hi) { const f32x2 v = {lo, hi}; return __builtin_bit_cast(unsigned, __builtin_convertvector(v, nbf16x2)); }
__device__ __forceinline__ bf16_t f2bf(float f) { return (bf16_t)(cvt_pk_bf16(f, 0.f) & 0xffffu); }
__device__ __forceinline__ float bf2f(unsigned short b) { return __builtin_bit_cast(float, ((unsigned)b) << 16); }
__device__ __forceinline__ float bflo(unsigned w) { return __builtin_bit_cast(float, w << 16); }
__device__ __forceinline__ float bfhi(unsigned w) { return __builtin_bit_cast(float, w & 0xffff0000u); }
__device__ __forceinline__ float fast_sigmoid(float x) { return __builtin_amdgcn_rcpf(1.f + __expf(-x)); }
__device__ __forceinline__ float gelu_tanh(float x) { const float u2 = 1.5957691216057308f * (x + 0.044715f * x * x * x); return x * __builtin_amdgcn_rcpf(1.f + __expf(-u2)); }
__device__ __forceinline__ float wave_sum(float v) {
#pragma unroll
    for (int o = 1; o < 64; o <<= 1) v += __shfl_xor(v, o);
    return v;
}
#define LDS_WAIT() asm volatile("s_waitcnt lgkmcnt(0)" ::: "memory")
#define VM_WAIT() asm volatile("s_waitcnt vmcnt(0)" ::: "memory")

namespace pg8 {
constexpr int BM = 256, BK = 64, HALF = 128, HTB = HALF * BK * 2, STAGE_BYTES = 8 * HTB, NXCD = 8, WGM = 8;
__host__ __device__ __forceinline__ int lds_byte(int r, int c) { const int st = (r >> 4) * 2 + (c >> 5), rr = r & 15, cc = c & 31, ob = rr * 64 + cc * 2; return st * 1024 + (ob ^ (((ob >> 9) & 1) << 5)); }
__host__ __device__ __forceinline__ void stage_rc(int b, int& R, int& C) { const int st = b / 1024, sb = b % 1024, swz = sb ^ (((sb >> 9) & 1) << 5); R = (st >> 1) * 16 + swz / 64; C = (st & 1) * 32 + (swz % 64) / 2; }
__host__ __device__ __forceinline__ int perm32(int rho) { const int n = rho >> 4, i = rho & 15; return 8 * (i >> 2) + 4 * n + (i & 3); }

struct Unit { int pm, pn; };
struct Gemm { const bf16_t* A; const bf16_t* Bt; int lda, ldb, K, akoff; };

struct StaticOrder {
    int nM, nN, nwg, G, c;
    __host__ __device__ void init(int M_, int N_, int G_, int c_) { nM = M_ / BM; nN = N_ / BM; nwg = nM * nN; G = G_; c = c_; }
    __host__ __device__ bool next(int i, Unit& u) const {
        const long L = (long)i * G + c; if (L >= nwg) return false;
        int wgid = (int)L; { const int q = nwg / NXCD, r = nwg % NXCD, xcd = wgid % NXCD, off = wgid / NXCD; wgid = (xcd < r ? xcd * (q + 1) : r * (q + 1) + (xcd - r) * q) + off; }
        const int nig = WGM * nN, gid = wgid / nig, fm = gid * WGM, gsz = (nM - fm) < WGM ? (nM - fm) : WGM;
        u.pm = fm + ((wgid % nig) % gsz); u.pn = (wgid % nig) / gsz; return true;
    }
};

template <class Epi, class Sched, bool ALIGN_EPI = true>
__device__ __forceinline__ void gemm_phase(LAS unsigned char* lds, const Gemm g, const Sched& S, const Epi& E) {
    const int tid = threadIdx.x, wid = __builtin_amdgcn_readfirstlane(tid >> 6), lane = tid & 63, wr = wid >> 2, wc = wid & 3, fr = lane & 15, fq = lane >> 4;
    const int K = g.K, nt = K / BK;
    unsigned voffA[2], voffB[2];
#pragma unroll
    for (int i = 0; i < 2; ++i) { int R, C; stage_rc(tid * 16 + i * 8192, R, C); const int Rb = Epi::PERM ? ((R & ~31) + perm32(R & 31)) : R;
        voffA[i] = (unsigned)(R * g.lda + C) * 2u; voffB[i] = (unsigned)(Rb * g.ldb + C) * 2u; }
    const size_t kstep = (size_t)(BK * 2);
    const size_t hstepA = (size_t)HALF * g.lda * 2, hstepB = (size_t)HALF * g.ldb * 2;
    const unsigned ldsw = (unsigned)wid * 1024u;
    const int aoff = lds_byte(wr * 64 + fr, fq * 8), boff = lds_byte(wc * 32 + fr, fq * 8);
#define PG8_SA(b, h) (((b) * 2 + (h)) * HTB)
#define PG8_SB(b, h) ((4 + (b) * 2 + (h)) * HTB)
#define PG8_STAGE(bufoff, gbase, voff) do { _Pragma("unroll") for (int _i = 0; _i < 2; ++_i) \
        __builtin_amdgcn_global_load_lds((const unsigned*)((const char*)(gbase) + (voff)[_i]), (LAS unsigned*)(lds + (bufoff) + ldsw + _i * 8192), 16, 0, 0); } while (0)
#define PG8_LDA(dst, b, h) do { _Pragma("unroll") for (int m = 0; m < 4; ++m) _Pragma("unroll") for (int k = 0; k < 2; ++k) dst[m][k] = *(const LAS bf16x8*)(lds + PG8_SA(b, h) + aoff + m * 2048 + k * 1024); } while (0)
#define PG8_LDB(dst, b, h) do { _Pragma("unroll") for (int n = 0; n < 2; ++n) _Pragma("unroll") for (int k = 0; k < 2; ++k) dst[n][k] = *(const LAS bf16x8*)(lds + PG8_SB(b, h) + boff + n * 2048 + k * 1024); } while (0)
#define PG8_MMA(ai, bj, At, Bt) do { __builtin_amdgcn_s_setprio(1); _Pragma("unroll") for (int m = 0; m < 4; ++m) _Pragma("unroll") for (int n = 0; n < 2; ++n) _Pragma("unroll") for (int k = 0; k < 2; ++k) \
        acc[ai][bj][m][n] = __builtin_amdgcn_mfma_f32_16x16x32_bf16(Bt[n][k], At[m][k], acc[ai][bj][m][n], 0, 0, 0); __builtin_amdgcn_s_setprio(0); } while (0)
#define PG8_WAIT_V(n) asm volatile("s_waitcnt vmcnt(" #n ")" ::: "memory")
#define PG8_WAIT_L(n) asm volatile("s_waitcnt lgkmcnt(" #n ")" ::: "memory")
#define PG8_BAR __builtin_amdgcn_s_barrier()
#define PG8_SCHED __builtin_amdgcn_sched_barrier(0)
#define PG8_APTR(u) ((const char*)g.A + ((size_t)(u).pm * BM * g.lda + (size_t)(u).pn * g.akoff) * 2)
#define PG8_BPTR(u) ((const char*)g.Bt + (size_t)(u).pn * BM * g.ldb * 2)
    Unit cur, nxt; int ui = 0;
    if (!S.next(0, cur)) return;
    f32x4 acc[2][2][4][2];
#pragma unroll
    for (int a = 0; a < 2; ++a)
#pragma unroll
        for (int b = 0; b < 2; ++b)
#pragma unroll
            for (int m = 0; m < 4; ++m)
#pragma unroll
                for (int n = 0; n < 2; ++n) acc[a][b][m][n] = (f32x4){0.f, 0.f, 0.f, 0.f};
    bf16x8 At[4][2], B0[2][2], B1[2][2];
    const char* cA = PG8_APTR(cur); const char* cB = PG8_BPTR(cur);
    PG8_STAGE(PG8_SB(0, 0), cB, voffB); PG8_STAGE(PG8_SB(0, 1), cB + hstepB, voffB); PG8_STAGE(PG8_SA(0, 0), cA, voffA); PG8_STAGE(PG8_SA(0, 1), cA + hstepA, voffA);
    if (wr == 1) PG8_BAR;
    PG8_WAIT_V(2); PG8_BAR;
    PG8_STAGE(PG8_SB(1, 0), cB + kstep, voffB); PG8_STAGE(PG8_SA(1, 0), cA + kstep, voffA); PG8_STAGE(PG8_SB(1, 1), cB + hstepB + kstep, voffB);
    PG8_WAIT_V(6); PG8_BAR;
    for (;;) {
        const bool has_next = S.next(ui + 1, nxt);
        const char* nA = has_next ? PG8_APTR(nxt) : cA; const char* nB = has_next ? PG8_BPTR(nxt) : cB;
        for (int t = 0; t < nt; t += 2) {
            const bool last = (t == nt - 2);
            const char* a1 = cA + (size_t)(t + 1) * kstep;
            const char* a2 = last ? nA : cA + (size_t)(t + 2) * kstep; const char* b2 = last ? nB : cB + (size_t)(t + 2) * kstep;
            const char* a3 = a2 + kstep; const char* b3 = b2 + kstep;
            PG8_LDB(B0, 0, 0); PG8_LDB(B1, 0, 1); PG8_SCHED; PG8_LDA(At, 0, 0); PG8_STAGE(PG8_SA(1, 1), a1 + hstepA, voffA);
            PG8_WAIT_V(8); PG8_WAIT_L(0); PG8_BAR; PG8_MMA(0, 0, At, B0); PG8_MMA(0, 1, At, B1); PG8_BAR; PG8_SCHED;
            PG8_LDA(At, 0, 1); PG8_STAGE(PG8_SB(0, 0), b2, voffB); PG8_STAGE(PG8_SB(0, 1), b2 + hstepB, voffB); PG8_STAGE(PG8_SA(0, 0), a2, voffA);
            PG8_WAIT_V(8); PG8_WAIT_L(0); PG8_BAR; PG8_MMA(1, 0, At, B0); PG8_MMA(1, 1, At, B1); PG8_BAR; PG8_SCHED;
            PG8_LDB(B0, 1, 0); PG8_LDB(B1, 1, 1); PG8_SCHED; PG8_LDA(At, 1, 0); PG8_STAGE(PG8_SA(0, 1), a2 + hstepA, voffA);
            PG8_WAIT_V(8); PG8_WAIT_L(0); PG8_BAR; PG8_MMA(0, 0, At, B0); PG8_MMA(0, 1, At, B1); PG8_BAR; PG8_SCHED;
            PG8_LDA(At, 1, 1); PG8_STAGE(PG8_SB(1, 0), b3, voffB); PG8_STAGE(PG8_SB(1, 1), b3 + hstepB, voffB); PG8_STAGE(PG8_SA(1, 0), a3, voffA);
            PG8_WAIT_V(8); PG8_WAIT_L(0); PG8_BAR; PG8_MMA(1, 0, At, B0); PG8_MMA(1, 1, At, B1); PG8_BAR; PG8_SCHED;
        }
        if constexpr (ALIGN_EPI) { if (wr == 0) PG8_BAR; }
        E(acc, cur, wr, wc, fr, fq);
        if (!has_next) break;
#pragma unroll
        for (int a = 0; a < 2; ++a)
#pragma unroll
            for (int b = 0; b < 2; ++b)
#pragma unroll
                for (int m = 0; m < 4; ++m)
#pragma unroll
                    for (int n = 0; n < 2; ++n) acc[a][b][m][n] = (f32x4){0.f, 0.f, 0.f, 0.f};
        cur = nxt; cA = nA; cB = nB; ++ui;
        if constexpr (ALIGN_EPI) { if (wr == 1) PG8_BAR; }
    }
    PG8_WAIT_V(0);
    if constexpr (!ALIGN_EPI) { if (wr == 0) PG8_BAR; }
    PG8_BAR;
#undef PG8_SA
#undef PG8_SB
#undef PG8_STAGE
#undef PG8_LDA
#undef PG8_LDB
#undef PG8_MMA
#undef PG8_WAIT_V
#undef PG8_WAIT_L
#undef PG8_BAR
#undef PG8_SCHED
#undef PG8_APTR
#undef PG8_BPTR
}

__device__ __forceinline__ u32x4 pack8(const f32x4 v0, const f32x4 v1) { u32x4 w; w.x = cvt_pk_bf16(v0[0], v0[1]); w.y = cvt_pk_bf16(v0[2], v0[3]); w.z = cvt_pk_bf16(v1[0], v1[1]); w.w = cvt_pk_bf16(v1[2], v1[3]); return w; }

struct EpiIn0 {
    static constexpr bool PERM = true;
    bf16_t* ZA; bf16_t* XB; f32x2* STAT;
    __device__ __forceinline__ void operator()(const f32x4 (&acc)[2][2][4][2], const Unit& u, int wr, int wc, int fr, int fq) const {
        const int row0 = u.pm * BM + wr * 64 + fr;
        if (u.pn < 8) {
            const int col0 = u.pn * BM + wc * 32 + 8 * fq; const bool st = (u.pn >= 4);
#pragma unroll
            for (int ai = 0; ai < 2; ++ai)
#pragma unroll
                for (int m = 0; m < 4; ++m) {
                    const int row = row0 + ai * HALF + m * 16;
                    f32x4 v[2][2];
#pragma unroll
                    for (int bj = 0; bj < 2; ++bj)
#pragma unroll
                        for (int n = 0; n < 2; ++n)
#pragma unroll
                            for (int j = 0; j < 4; ++j) v[bj][n][j] = gelu_tanh(acc[ai][bj][m][n][j]);
                    if (st) {
                        float s = 0.f;
#pragma unroll
                        for (int bj = 0; bj < 2; ++bj)
#pragma unroll
                            for (int n = 0; n < 2; ++n) s += (v[bj][n][0] + v[bj][n][1]) + (v[bj][n][2] + v[bj][n][3]);
                        s += __shfl_xor(s, 16); s += __shfl_xor(s, 32);
                        const float mw = s * (1.0f / 64.0f); float q = 0.f;
#pragma unroll
                        for (int bj = 0; bj < 2; ++bj)
#pragma unroll
                            for (int n = 0; n < 2; ++n) { const f32x4 d = v[bj][n] - mw; q += (d[0] * d[0] + d[1] * d[1]) + (d[2] * d[2] + d[3] * d[3]); }
                        q += __shfl_xor(q, 16); q += __shfl_xor(q, 32);
                        if (fq == 0) STAT[(size_t)row * 16 + (u.pn - 4) * 4 + wc] = (f32x2){mw, q};
                    }
                    bf16_t* rowp = ZA + (size_t)row * 2048 + col0;
#pragma unroll
                    for (int bj = 0; bj < 2; ++bj) *(u32x4*)(rowp + bj * HALF) = pack8(v[bj][0], v[bj][1]);
                }
        } else {
            const int col0 = (u.pn - 8) * BM + wc * 32 + 8 * fq;
#pragma unroll
            for (int ai = 0; ai < 2; ++ai)
#pragma unroll
                for (int m = 0; m < 4; ++m) { bf16_t* rowp = XB + (size_t)(row0 + ai * HALF + m * 16) * 1024 + col0;
#pragma unroll
                    for (int bj = 0; bj < 2; ++bj) *(u32x4*)(rowp + bj * HALF) = pack8(acc[ai][bj][m][0], acc[ai][bj][m][1]); }
        }
    }
};
struct EpiBf16 {
    static constexpr bool PERM = true;
    bf16_t* O; int ldc; int coloff; const float* scale;
    __device__ __forceinline__ void operator()(const f32x4 (&acc)[2][2][4][2], const Unit& u, int wr, int wc, int fr, int fq) const {
        const int row0 = u.pm * BM + wr * 64 + fr, lc0 = u.pn * BM + wc * 32 + 8 * fq;
        f32x4 sc[2][2];
#pragma unroll
        for (int bj = 0; bj < 2; ++bj)
#pragma unroll
            for (int n = 0; n < 2; ++n) sc[bj][n] = scale ? *(const f32x4*)(scale + lc0 + bj * HALF + 4 * n) : (f32x4){1.f, 1.f, 1.f, 1.f};
#pragma unroll
        for (int ai = 0; ai < 2; ++ai)
#pragma unroll
            for (int m = 0; m < 4; ++m) { bf16_t* rowp = O + (size_t)(row0 + ai * HALF + m * 16) * ldc + coloff + lc0;
#pragma unroll
                for (int bj = 0; bj < 2; ++bj) *(u32x4*)(rowp + bj * HALF) = pack8(acc[ai][bj][m][0] * sc[bj][0], acc[ai][bj][m][1] * sc[bj][1]); }
    }
};
struct EpiRes {
    static constexpr bool PERM = false;
    const float* xsrc; float* XF;
    __device__ __forceinline__ void operator()(const f32x4 (&acc)[2][2][4][2], const Unit& u, int wr, int wc, int fr, int fq) const {
        const int row0 = u.pm * BM + wr * 64 + fr, col0 = u.pn * BM + wc * 32 + 4 * fq;
#pragma unroll
        for (int ai = 0; ai < 2; ++ai)
#pragma unroll
            for (int m = 0; m < 4; ++m) { const size_t off = (size_t)(row0 + ai * HALF + m * 16) * D + col0;
#pragma unroll
                for (int bj = 0; bj < 2; ++bj)
#pragma unroll
                    for (int n = 0; n < 2; ++n) { const f32x4 xs = *(const f32x4*)(xsrc + off + bj * HALF + n * 16); *(f32x4*)(XF + off + bj * HALF + n * 16) = xs * ALPHA + acc[ai][bj][m][n]; }
                asm volatile("" ::: "memory"); }
    }
};
struct EpiIn1 {
    static constexpr bool PERM = true;
    unsigned char* base;
    __device__ __forceinline__ void operator()(const f32x4 (&acc)[2][2][4][2], const Unit& u, int wr, int wc, int fr, int fq) const {
        const int row0 = u.pm * BM + wr * 64 + fr, sec = u.pn >> 3, col0 = (u.pn & 7) * BM + wc * 32 + 8 * fq;
        float* FL = (float*)(base + (size_t)32 * 1048576);
        if (sec == 1) {
#pragma unroll
            for (int ai = 0; ai < 2; ++ai)
#pragma unroll
                for (int m = 0; m < 4; ++m) { float* rowp = FL + (size_t)(row0 + ai * HALF + m * 16) * 2048 + col0;
#pragma unroll
                    for (int bj = 0; bj < 2; ++bj) { *(f32x4*)(rowp + bj * HALF) = acc[ai][bj][m][0]; *(f32x4*)(rowp + bj * HALF + 4) = acc[ai][bj][m][1]; } }
        } else {
            bf16_t* O = (bf16_t*)(base + (size_t)(sec + (sec >= 2 ? 1 : 0)) * ((size_t)32 * 1048576));
#pragma unroll
            for (int ai = 0; ai < 2; ++ai)
#pragma unroll
                for (int m = 0; m < 4; ++m) { bf16_t* rowp = O + (size_t)(row0 + ai * HALF + m * 16) * 2048 + col0;
#pragma unroll
                    for (int bj = 0; bj < 2; ++bj) { f32x4 v0 = acc[ai][bj][m][0], v1 = acc[ai][bj][m][1];
                        if (sec == 0) {
#pragma unroll
                            for (int j = 0; j < 4; ++j) { v0[j] = v0[j] * fast_sigmoid(v0[j]); v1[j] = v1[j] * fast_sigmoid(v1[j]); } }
                        if (sec == 3) {
#pragma unroll
                            for (int j = 0; j < 4; ++j) { v0[j] = fast_sigmoid(v0[j]); v1[j] = fast_sigmoid(v1[j]); } }
                        *(u32x4*)(rowp + bj * HALF) = pack8(v0, v1); } }
        }
    }
};
}

#define XB_TMO      128
#define XB_XCNT(j)  (256  + 64 * (j))
#define XB_XSUB(j)  (1280 + 64 * (j))
#define XB_XGEN(j)  (2304 + 64 * (j))
#define XB_TOP      3328
#define XB_TOPGEN   3392
#define XCD_BAR_WORDS 3456
#define XB_SPIN_CAP (1u << 18)
__device__ __forceinline__ unsigned xb_ld(unsigned* p)              { return __hip_atomic_load(p, __ATOMIC_RELAXED, __HIP_MEMORY_SCOPE_AGENT); }
__device__ __forceinline__ unsigned xb_add(unsigned* p, unsigned v) { return __hip_atomic_fetch_add(p, v, __ATOMIC_RELAXED, __HIP_MEMORY_SCOPE_AGENT); }
__device__ __forceinline__ unsigned xb_xcc_id() { return (unsigned)__builtin_amdgcn_s_getreg((3 << 11) | 20) & 0xFu; }
#define XB_SPIN(cond, bar) do { unsigned _sp = 0; while (cond) { __builtin_amdgcn_s_sleep(1); \
    if ((++_sp & 255u) == 0u) { if (xb_ld(&(bar)[XB_TMO])) break; if (_sp > XB_SPIN_CAP) { atomicAdd(&(bar)[XB_TMO], 1u); break; } } } } while (0)
struct XcdBarrier { unsigned* bar; unsigned x; volatile LAS unsigned* st; };
__device__ __forceinline__ XcdBarrier xcd_barrier_post(unsigned* bar, volatile LAS unsigned* st) {
    XcdBarrier b; b.bar = bar; b.x = xb_xcc_id(); b.st = st;
    if (threadIdx.x == 0) (void)xb_add(&bar[XB_XCNT(b.x)], 1u);
    return b;
}
__device__ __forceinline__ void xcd_barrier_complete(unsigned* bar, unsigned x, unsigned& nloc, unsigned& nx) {
    const unsigned G = gridDim.x * gridDim.y * gridDim.z;
    unsigned sum, cnt, mine, sp = 0u;
    for (;;) {
        sum = 0u; cnt = 0u; mine = 0u;
#pragma unroll
        for (unsigned j = 0; j < 16; ++j) { const unsigned c = xb_ld(&bar[XB_XCNT(j)]); sum += c; cnt += (c > 0u) ? 1u : 0u; mine = (j == x) ? c : mine; }
        if (sum == G) break;
        __builtin_amdgcn_s_sleep(1);
        if ((++sp & 255u) == 0u) { if (xb_ld(&bar[XB_TMO])) break; if (sp > XB_SPIN_CAP) { atomicAdd(&bar[XB_TMO], 1u); break; } }
    }
    nloc = mine > 0u ? mine : 1u; nx = cnt > 0u ? cnt : 1u;
}
__device__ __forceinline__ void xcd_barrier(const XcdBarrier& b) {
    asm volatile("s_waitcnt vmcnt(0)" ::: "memory");
    __syncthreads();
    if (threadIdx.x == 0) {
        unsigned* bar = b.bar;
        __builtin_amdgcn_s_waitcnt(0);
        unsigned nloc = b.st[0], nx = b.st[1];
        if (nloc == 0u) { xcd_barrier_complete(bar, b.x, nloc, nx); b.st[0] = nloc; b.st[1] = nx; }
        const unsigned old = xb_add(&bar[XB_XSUB(b.x)], 1u);
        const unsigned gen = old / nloc;
        if (old + 1u == (gen + 1u) * nloc) {
            __builtin_amdgcn_fence(__ATOMIC_RELEASE, "agent");
            asm volatile("s_waitcnt vmcnt(0)" ::: "memory");
            const unsigned og = xb_add(&bar[XB_TOP], 1u);
            const unsigned tg = og / nx;
            if (og + 1u == (tg + 1u) * nx) xb_add(&bar[XB_TOPGEN], 1u);
            else XB_SPIN(xb_ld(&bar[XB_TOPGEN]) == tg, bar);
            __builtin_amdgcn_fence(__ATOMIC_ACQUIRE, "agent");
            xb_add(&bar[XB_XGEN(b.x)], 1u);
            asm volatile("s_waitcnt vmcnt(0)" ::: "memory");
        } else {
            XB_SPIN(xb_ld(&bar[XB_XGEN(b.x)]) == gen, bar);
            __builtin_amdgcn_fence(__ATOMIC_ACQUIRE, "agent");
            asm volatile("s_waitcnt vmcnt(0)" ::: "memory");
        }
    }
    __syncthreads();
}

struct Args { const float* in[21]; float* out; unsigned char* ws; int ph_lo, ph_hi; };
struct Frame {
    LAS unsigned char* lds;
    int tid, lane, wave, vcu, G;
    unsigned char* ws;
};

__device__ __forceinline__ void p0_transpose_item(const float* W, int K, int N, bf16_t* WT, LAS float* scr, int item, int lane) {
    const int nblk = N / 64, kb = item / nblk, nb = item % nblk, k0 = 64 * kb, n0 = 64 * nb;
#pragma unroll 8
    for (int i = 0; i < 64; ++i) scr[i * 65 + lane] = W[(size_t)(k0 + i) * N + n0 + lane];
    LDS_WAIT(); asm volatile("" ::: "memory");
    const int c = lane & 7;
#pragma unroll
    for (int j = 0; j < 8; ++j) { const int n = (lane >> 3) + 8 * j; const LAS float* s = scr + (8 * c) * 65 + n;
        u32x4 o; o.x = cvt_pk_bf16(s[0 * 65], s[1 * 65]); o.y = cvt_pk_bf16(s[2 * 65], s[3 * 65]); o.z = cvt_pk_bf16(s[4 * 65], s[5 * 65]); o.w = cvt_pk_bf16(s[6 * 65], s[7 * 65]);
        *(u32x4*)(WT + (size_t)(n0 + n) * K + k0 + 8 * c) = o; }
    LDS_WAIT(); asm volatile("" ::: "memory");
}
__device__ __forceinline__ void p0_prologue(Frame& F, const Args& a) {
    LAS float* scr = (LAS float*)(F.lds + F.wave * 16640);
    const int gw = F.vcu * NWAVES + F.wave, NGW = F.G * NWAVES;
    unsigned char* ws = F.ws;
    constexpr int I_IN0 = (D / 64) * (NIN0 / 64), I_POOL = 4 * 16, I_OUT = (D / 64) * (D / 64), I_IN1 = (D / 64) * (NIN1 / 64), I_UP = (D / 64) * (NUP / 64), I_DN = (DFF / 64) * (D / 64);
    constexpr int NITEMS = I_IN0 + I_POOL + 2 * I_OUT + I_IN1 + 2 * I_UP + 2 * I_DN;
    for (int it = gw; it < NITEMS; it += NGW) {
        int r = it;
        if (r < I_IN0) { p0_transpose_item(a.in[1], D, NIN0, (bf16_t*)(ws + WS_WIN0), scr, r, F.lane); continue; } r -= I_IN0;
        if (r < I_POOL) { const int g = r >> 4; p0_transpose_item(a.in[6] + (size_t)g * 65536, 256, 256, (bf16_t*)(ws + WS_WPOOL) + (size_t)g * 65536, scr, r & 15, F.lane); continue; } r -= I_POOL;
        if (r < I_OUT) { p0_transpose_item(a.in[8], D, D, (bf16_t*)(ws + WS_WOUT0), scr, r, F.lane); continue; } r -= I_OUT;
        if (r < I_OUT) { p0_transpose_item(a.in[11], D, D, (bf16_t*)(ws + WS_WOUT1), scr, r, F.lane); continue; } r -= I_OUT;
        if (r < I_IN1) { p0_transpose_item(a.in[9], D, NIN1, (bf16_t*)(ws + WS_WIN1), scr, r, F.lane); continue; } r -= I_IN1;
        if (r < 2 * I_UP) { const int l = r / I_UP; p0_transpose_item(a.in[13] + (size_t)l * D * NUP, D, NUP, (bf16_t*)(ws + WS_WUP) + (size_t)l * D * NUP, scr, r % I_UP, F.lane); continue; } r -= 2 * I_UP;
        { const int l = r / I_DN; p0_transpose_item(a.in[16] + (size_t)l * DFF * D, DFF, D, (bf16_t*)(ws + WS_WDOWN) + (size_t)l * DFF * D, scr, r % I_DN, F.lane); }
    }
    const float* x = a.in[0]; bf16_t* XN = (bf16_t*)(ws + WS_XN);
    for (size_t i = (size_t)blockIdx.x * NTHREADS + F.tid; i < (size_t)M * D / 8; i += (size_t)F.G * NTHREADS) {
        const f32x4 v0 = *(const f32x4*)(x + i * 8), v1 = *(const f32x4*)(x + i * 8 + 4);
        *(u32x4*)(XN + i * 8) = pg8::pack8(v0, v1);
    }
}

__device__ __forceinline__ void ln_phase(Frame& F, const float* src, float* dstf, bf16_t* dstb, const float* g, const float* b) {
    const int gw = F.vcu * NWAVES + F.wave, NGW = F.G * NWAVES;
    for (int row = gw; row < M; row += NGW) {
        const f32x4* xr = (const f32x4*)(src + (size_t)row * D) + F.lane;
        f32x4 v[8]; float s = 0.f;
#pragma unroll
        for (int j = 0; j < 8; ++j) { v[j] = xr[64 * j]; s += (v[j][0] + v[j][1]) + (v[j][2] + v[j][3]); }
        const float mean = wave_sum(s) * (1.f / D); float q = 0.f;
#pragma unroll
        for (int j = 0; j < 8; ++j) { v[j] = v[j] - mean; q += (v[j][0] * v[j][0] + v[j][1] * v[j][1]) + (v[j][2] * v[j][2] + v[j][3] * v[j][3]); }
        const float rstd = rsqrtf(wave_sum(q) * (1.f / D) + LN_EPS);
#pragma unroll
        for (int j = 0; j < 8; ++j) {
            const f32x4 gg = *((const f32x4*)g + F.lane + 64 * j), bb = *((const f32x4*)b + F.lane + 64 * j);
            const f32x4 o = v[j] * rstd * gg + bb;
            *((f32x4*)(dstf + (size_t)row * D) + F.lane + 64 * j) = o;
            if (dstb) { u32x2 w; w.x = cvt_pk_bf16(o[0], o[1]); w.y = cvt_pk_bf16(o[2], o[3]); *((u32x2*)(dstb + (size_t)row * D) + F.lane + 64 * j) = w; }
        }
    }
}

__device__ __forceinline__ void conv_phase(Frame& F, const bf16_t* HB, const float* cw, const float* cb, bf16_t* GB) {
    constexpr int RUN = 16, NC8 = DFF / 8, NITEM = (M / RUN) * NC8;
    for (int it = blockIdx.x * NTHREADS + F.tid; it < NITEM; it += F.G * NTHREADS) {
        const int rb = it / NC8, c8 = it % NC8, r0 = rb * RUN, c = c8 * 8;
        float w0[2][8], w1[2][8], w2[2][8], bb[2][8];
#pragma unroll
        for (int p = 0; p < 2; ++p)
#pragma unroll
            for (int h = 0; h < 2; ++h) {
                const f32x4 a0 = *(const f32x4*)(cw + 0 * NUP + p * DFF + c + 4 * h), a1 = *(const f32x4*)(cw + 1 * NUP + p * DFF + c + 4 * h), a2 = *(const f32x4*)(cw + 2 * NUP + p * DFF + c + 4 * h), ab = *(const f32x4*)(cb + p * DFF + c + 4 * h);
#pragma unroll
                for (int j = 0; j < 4; ++j) { w0[p][4 * h + j] = a0[j]; w1[p][4 * h + j] = a1[j]; w2[p][4 * h + j] = a2[j]; bb[p][4 * h + j] = ab[j]; }
            }
        float hm2[2][8], hm1[2][8];
        const bool first = ((r0 & (T - 1)) == 0);
#pragma unroll
        for (int p = 0; p < 2; ++p) {
            u32x4 x2 = (u32x4){0u, 0u, 0u, 0u}, x1 = (u32x4){0u, 0u, 0u, 0u};
            if (!first) { x2 = *(const u32x4*)(HB + (size_t)(r0 - 2) * NUP + p * DFF + c); x1 = *(const u32x4*)(HB + (size_t)(r0 - 1) * NUP + p * DFF + c); }
#pragma unroll
            for (int j = 0; j < 4; ++j) { hm2[p][2 * j] = bflo(x2[j]); hm2[p][2 * j + 1] = bfhi(x2[j]); hm1[p][2 * j] = bflo(x1[j]); hm1[p][2 * j + 1] = bfhi(x1[j]); }
        }
#pragma unroll 4
        for (int i = 0; i < RUN; ++i) {
            float hc[2][8];
#pragma unroll
            for (int p = 0; p < 2; ++p) {
                const u32x4 x0 = *(const u32x4*)(HB + (size_t)(r0 + i) * NUP + p * DFF + c);
                float h0[8];
#pragma unroll
                for (int j = 0; j < 4; ++j) { h0[2 * j] = bflo(x0[j]); h0[2 * j + 1] = bfhi(x0[j]); }
#pragma unroll
                for (int j = 0; j < 8; ++j) { hc[p][j] = bb[p][j] + w2[p][j] * h0[j] + w1[p][j] * hm1[p][j] + w0[p][j] * hm2[p][j]; hm2[p][j] = hm1[p][j]; hm1[p][j] = h0[j]; }
            }
            float o[8];
#pragma unroll
            for (int j = 0; j < 8; ++j) o[j] = hc[0][j] * fast_sigmoid(hc[0][j]) * hc[1][j];
            u32x4 w; w.x = cvt_pk_bf16(o[0], o[1]); w.y = cvt_pk_bf16(o[2], o[3]); w.z = cvt_pk_bf16(o[4], o[5]); w.w = cvt_pk_bf16(o[6], o[7]);
            *(u32x4*)(GB + (size_t)(r0 + i) * DFF + c) = w;
        }
    }
}

__device__ __forceinline__ void mixer_a_unit(Frame& F, int unit, const bf16_t* ZA, const f32x2* STAT, const float* Ws, const float* bs, const float* lng, const float* lnb, bf16_t* CAT) {
    constexpr int PITCH = 136;
    LAS bf16_t* WA = (LAS bf16_t*)F.lds;
    LAS bf16_t* VT = (LAS bf16_t*)(F.lds + 128 * PITCH * 2);
    LAS f32x2* RS = (LAS f32x2*)(F.lds + 2 * 128 * PITCH * 2);
    const int n = unit >> 3, h = unit & 7, r0 = n * 128, c0 = h * 128, tid = F.tid;
    if (tid < 128) {
        const f32x2* sp = STAT + (size_t)(r0 + tid) * 16; float mt = 0.f; f32x2 p[16];
#pragma unroll
        for (int i = 0; i < 16; ++i) { p[i] = sp[i]; mt += p[i].x; }
        mt *= (1.f / 16.f); float m2 = 0.f;
#pragma unroll
        for (int i = 0; i < 16; ++i) { const float dm = p[i].x - mt; m2 += p[i].y + 64.f * dm * dm; }
        RS[tid] = (f32x2){mt, rsqrtf(m2 * (1.f / 1024.f) + LN_EPS)};
    }
    {
        const float* w = Ws + (size_t)h * 16384;
#pragma unroll
        for (int j = 0; j < 8; ++j) { const int idx = tid + 512 * j, t = idx >> 5, s4 = (idx & 31) * 4; f32x4 v = *(const f32x4*)(w + t * 128 + s4);
#pragma unroll
            for (int q = 0; q < 4; ++q) v[q] = (s4 + q <= t) ? v[q] : 0.f;
            u32x2 o; o.x = cvt_pk_bf16(v[0], v[1]); o.y = cvt_pk_bf16(v[2], v[3]); *(LAS u32x2*)(WA + t * PITCH + s4) = o; }
    }
    __syncthreads();
    {
        const int seg = tid >> 7, c = tid & 127; const float gg = lng[c0 + c], bb = lnb[c0 + c];
        const bf16_t* vp = ZA + (size_t)(r0 + 32 * seg) * 2048 + 1024 + c0 + c;
#pragma unroll
        for (int q4 = 0; q4 < 4; ++q4) {
            float v[8];
#pragma unroll
            for (int i = 0; i < 8; ++i) { const int s = 8 * q4 + i; const f32x2 rs = RS[32 * seg + s]; v[i] = (bf2f(vp[(size_t)s * 2048]) - rs.x) * rs.y * gg + bb; }
            u32x4 o; o.x = cvt_pk_bf16(v[0], v[1]); o.y = cvt_pk_bf16(v[2], v[3]); o.z = cvt_pk_bf16(v[4], v[5]); o.w = cvt_pk_bf16(v[6], v[7]);
            *(LAS u32x4*)(VT + c * PITCH + 32 * seg + 8 * q4) = o;
        }
    }
    __syncthreads();
    const int wid = F.wave, lane = F.lane, wr = wid >> 2, wc = wid & 3, fr = lane & 15, fq = lane >> 4;
    f32x4 acc[4][2];
#pragma unroll
    for (int m = 0; m < 4; ++m)
#pragma unroll
        for (int nn = 0; nn < 2; ++nn) acc[m][nn] = (f32x4){0.f, 0.f, 0.f, 0.f};
#pragma unroll
    for (int ks = 0; ks < 4; ++ks) {
        bf16x8 af[4], bfr[2];
#pragma unroll
        for (int m = 0; m < 4; ++m) af[m] = *(const LAS bf16x8*)(WA + (64 * wr + 16 * m + fr) * PITCH + 32 * ks + 8 * fq);
#pragma unroll
        for (int nn = 0; nn < 2; ++nn) bfr[nn] = *(const LAS bf16x8*)(VT + (32 * wc + 16 * nn + fr) * PITCH + 32 * ks + 8 * fq);
#pragma unroll
        for (int m = 0; m < 4; ++m)
#pragma unroll
            for (int nn = 0; nn < 2; ++nn) acc[m][nn] = __builtin_amdgcn_mfma_f32_16x16x32_bf16(bfr[nn], af[m], acc[m][nn], 0, 0, 0);
    }
#pragma unroll
    for (int m = 0; m < 4; ++m) { const int t = 64 * wr + 16 * m + fr; const float bt = bs[h * 128 + t];
#pragma unroll
        for (int nn = 0; nn < 2; ++nn) { const int c = 32 * wc + 16 * nn + 4 * fq; const u32x2 uu = *(const u32x2*)(ZA + (size_t)(r0 + t) * 2048 + c0 + c);
            const f32x4 s = acc[m][nn] + bt; u32x2 o; o.x = cvt_pk_bf16(bflo(uu.x) * s[0], bfhi(uu.x) * s[1]); o.y = cvt_pk_bf16(bflo(uu.y) * s[2], bfhi(uu.y) * s[3]);
            *(u32x2*)(CAT + (size_t)(r0 + t) * 2048 + c0 + c) = o; } }
    __syncthreads();
}
__device__ __forceinline__ void pool_items(Frame& F, const bf16_t* XB, bf16_t* PB) {
    constexpr int NITEM = M * 128;
    for (int it = blockIdx.x * NTHREADS + F.tid; it < NITEM; it += F.G * NTHREADS) {
        const int row = it >> 7, c8 = it & 127, g = c8 >> 5, t = row & (T - 1), win = 2 << g, n = (t + 1 < win) ? t + 1 : win;
        float s[8];
#pragma unroll
        for (int j = 0; j < 8; ++j) s[j] = 0.f;
        float x0[8];
        for (int k = 0; k < n; ++k) { const u32x4 x = *(const u32x4*)(XB + (size_t)(row - k) * 1024 + c8 * 8);
#pragma unroll
            for (int j = 0; j < 4; ++j) { const float lo = bflo(x[j]), hi = bfhi(x[j]); s[2 * j] += lo; s[2 * j + 1] += hi; if (k == 0) { x0[2 * j] = lo; x0[2 * j + 1] = hi; } } }
        const float inv = 1.f / (float)n; u32x4 w;
        w.x = cvt_pk_bf16(s[0] * inv - x0[0], s[1] * inv - x0[1]); w.y = cvt_pk_bf16(s[2] * inv - x0[2], s[3] * inv - x0[3]);
        w.z = cvt_pk_bf16(s[4] * inv - x0[4], s[5] * inv - x0[5]); w.w = cvt_pk_bf16(s[6] * inv - x0[6], s[7] * inv - x0[7]);
        *(u32x4*)(PB + (size_t)row * 1024 + c8 * 8) = w;
    }
}

struct ChunkPrep { float bcum[16], kk[16], blast; };
__device__ __forceinline__ void chunk_prep(Frame& F, ChunkPrep& P, const float* FL, const float* lbp, int r0, int c0, LAS float* TOT) {
    const int seg = F.tid >> 7, d = F.tid & 127;
    const float p0 = lbp[c0 + d], p1 = lbp[DC + c0 + d];
    const float lb = __builtin_amdgcn_rcpf(1.f + __expf(p0 - p1));
    const float* fp = FL + (size_t)(r0 + 16 * seg) * 2048 + c0 + d;
    float run = 0.f;
#pragma unroll
    for (int i = 0; i < 16; ++i) { const float x = fp[(size_t)i * 2048]; const float sg = fast_sigmoid(x); const float f = lb + (1.f - lb) * sg; P.kk[i] = (1.f - lb) * (1.f - sg); run += __logf(f); P.bcum[i] = run; }
    TOT[seg * 128 + d] = run;
    __syncthreads();
    const float t0 = TOT[d], t1 = TOT[128 + d], t2 = TOT[256 + d], t3 = TOT[384 + d];
    const float off = (seg > 0 ? t0 : 0.f) + (seg > 1 ? t1 : 0.f) + (seg > 2 ? t2 : 0.f);
    P.blast = (t0 + t1) + (t2 + t3);
#pragma unroll
    for (int i = 0; i < 16; ++i) P.bcum[i] += off;
}
__device__ __forceinline__ void h1_unit(Frame& F, int unit, const float* FL, const bf16_t* VB, const float* lbp, bf16_t* UPD, float* DEC) {
    constexpr int P64 = 72;
    LAS bf16_t* KEt = (LAS bf16_t*)F.lds;
    LAS bf16_t* Vt = (LAS bf16_t*)(F.lds + 128 * P64 * 2);
    LAS float* TOT = (LAS float*)(F.lds + 2 * 128 * P64 * 2);
    const int bh = unit >> 6, n = unit & 63, b = bh >> 4, h = bh & 15, r0 = b * T + 64 * n, c0 = 128 * h;
    const int seg = F.tid >> 7, d = F.tid & 127;
    ChunkPrep P; chunk_prep(F, P, FL, lbp, r0, c0, TOT);
    {
        float ke[16];
#pragma unroll
        for (int i = 0; i < 16; ++i) ke[i] = P.kk[i] * __expf(P.blast - P.bcum[i]);
        u32x4 o0, o1; o0.x = cvt_pk_bf16(ke[0], ke[1]); o0.y = cvt_pk_bf16(ke[2], ke[3]); o0.z = cvt_pk_bf16(ke[4], ke[5]); o0.w = cvt_pk_bf16(ke[6], ke[7]);
        o1.x = cvt_pk_bf16(ke[8], ke[9]); o1.y = cvt_pk_bf16(ke[10], ke[11]); o1.z = cvt_pk_bf16(ke[12], ke[13]); o1.w = cvt_pk_bf16(ke[14], ke[15]);
        *(LAS u32x4*)(KEt + d * P64 + 16 * seg) = o0; *(LAS u32x4*)(KEt + d * P64 + 16 * seg + 8) = o1;
        const bf16_t* vp = VB + (size_t)(r0 + 16 * seg) * 2048 + c0 + d; unsigned vv[8];
#pragma unroll
        for (int i = 0; i < 8; ++i) vv[i] = (unsigned)vp[(size_t)(2 * i) * 2048] | ((unsigned)vp[(size_t)(2 * i + 1) * 2048] << 16);
        *(LAS u32x4*)(Vt + d * P64 + 16 * seg) = (u32x4){vv[0], vv[1], vv[2], vv[3]}; *(LAS u32x4*)(Vt + d * P64 + 16 * seg + 8) = (u32x4){vv[4], vv[5], vv[6], vv[7]};
        if (seg == 0) DEC[(size_t)unit * 128 + d] = __expf(P.blast);
    }
    __syncthreads();
    const int wid = F.wave, lane = F.lane, wr = wid >> 2, wc = wid & 3, fr = lane & 15, fq = lane >> 4;
    f32x4 acc[4][2];
#pragma unroll
    for (int m = 0; m < 4; ++m)
#pragma unroll
        for (int nn = 0; nn < 2; ++nn) acc[m][nn] = (f32x4){0.f, 0.f, 0.f, 0.f};
#pragma unroll
    for (int ks = 0; ks < 2; ++ks) {
        bf16x8 af[4], bfr[2];
#pragma unroll
        for (int m = 0; m < 4; ++m) af[m] = *(const LAS bf16x8*)(Vt + (64 * wr + 16 * m + fr) * P64 + 32 * ks + 8 * fq);
#pragma unroll
        for (int nn = 0; nn < 2; ++nn) bfr[nn] = *(const LAS bf16x8*)(KEt + (32 * wc + 16 * nn + fr) * P64 + 32 * ks + 8 * fq);
#pragma unroll
        for (int m = 0; m < 4; ++m)
#pragma unroll
            for (int nn = 0; nn < 2; ++nn) acc[m][nn] = __builtin_amdgcn_mfma_f32_16x16x32_bf16(bfr[nn], af[m], acc[m][nn], 0, 0, 0);
    }
    bf16_t* up = UPD + (size_t)unit * 16384;
#pragma unroll
    for (int m = 0; m < 4; ++m)
#pragma unroll
        for (int nn = 0; nn < 2; ++nn) { const int e = 64 * wr + 16 * m + fr, dd = 32 * wc + 16 * nn + 4 * fq; u32x2 o; o.x = cvt_pk_bf16(acc[m][nn][0], acc[m][nn][1]); o.y = cvt_pk_bf16(acc[m][nn][2], acc[m][nn][3]); *(u32x2*)(up + e * 128 + dd) = o; }
    __syncthreads();
}
__device__ __forceinline__ void h2_scan(Frame& F, bf16_t* UPD, const float* DEC) {
    const int gt = blockIdx.x * NTHREADS + F.tid;
    if (gt >= 32 * 128 * 32) return;
    const int bh = gt >> 12, e = (gt >> 5) & 127, d4 = (gt & 31) * 4;
    bf16_t* up = UPD + (size_t)bh * 64 * 16384 + e * 128 + d4; const float* dp = DEC + (size_t)bh * 64 * 128 + d4;
    f32x4 S = (f32x4){0.f, 0.f, 0.f, 0.f};
    for (int nb = 0; nb < 64; nb += 8) {
        u32x2 u[8]; f32x4 dc[8];
#pragma unroll
        for (int i = 0; i < 8; ++i) { u[i] = *(const u32x2*)(up + (size_t)(nb + i) * 16384); dc[i] = *(const f32x4*)(dp + (size_t)(nb + i) * 128); }
#pragma unroll
        for (int i = 0; i < 8; ++i) {
            u32x2 o; o.x = cvt_pk_bf16(S[0], S[1]); o.y = cvt_pk_bf16(S[2], S[3]); *(u32x2*)(up + (size_t)(nb + i) * 16384) = o;
            S[0] = dc[i][0] * S[0] + bflo(u[i].x); S[1] = dc[i][1] * S[1] + bfhi(u[i].x); S[2] = dc[i][2] * S[2] + bflo(u[i].y); S[3] = dc[i][3] * S[3] + bfhi(u[i].y);
        }
    }
}
__device__ __forceinline__ void h3_unit(Frame& F, int unit, const bf16_t* QB, const float* FL, const bf16_t* VB, const bf16_t* SG, const float* lbp, const bf16_t* UPD, const float* gn, bf16_t* YB) {
    constexpr int P128 = 136, P64 = 72;
    LAS bf16_t* QD = (LAS bf16_t*)F.lds;
    LAS bf16_t* KD = (LAS bf16_t*)(F.lds + 17408);
    LAS bf16_t* Vt = (LAS bf16_t*)(F.lds + 34816);
    LAS bf16_t* ATT = (LAS bf16_t*)(F.lds + 53248);
    LAS bf16_t* SPt = (LAS bf16_t*)(F.lds + 62464);
    LAS float* TOT = (LAS float*)(F.lds + 97280);
    LAS float* SS = (LAS float*)(F.lds + 99328);
    const int bh = unit >> 6, n = unit & 63, b = bh >> 4, h = bh & 15, r0 = b * T + 64 * n, c0 = 128 * h;
    const int tid = F.tid, seg = tid >> 7, d = tid & 127;
    {
        const bf16_t* up = UPD + (size_t)unit * 16384;
#pragma unroll
        for (int j = 0; j < 4; ++j) { const int idx = tid + 512 * j, e = idx >> 4, d8 = (idx & 15) * 8; *(LAS u32x4*)(SPt + e * P128 + d8) = *(const u32x4*)(up + e * 128 + d8); }
    }
    ChunkPrep P; chunk_prep(F, P, FL, lbp, r0, c0, TOT);
    {
        const bf16_t* qp = QB + (size_t)(r0 + 16 * seg) * 2048 + c0 + d; const bf16_t* vp = VB + (size_t)(r0 + 16 * seg) * 2048 + c0 + d;
        unsigned vv[8];
#pragma unroll
        for (int i = 0; i < 16; ++i) {
            const float q = bf2f(qp[(size_t)i * 2048]);
            QD[(16 * seg + i) * P128 + d] = f2bf(q * __expf(P.bcum[i]));
            KD[(16 * seg + i) * P128 + d] = f2bf(P.kk[i] * __expf(-P.bcum[i]));
        }
#pragma unroll
        for (int i = 0; i < 8; ++i) vv[i] = (unsigned)vp[(size_t)(2 * i) * 2048] | ((unsigned)vp[(size_t)(2 * i + 1) * 2048] << 16);
        *(LAS u32x4*)(Vt + d * P64 + 16 * seg) = (u32x4){vv[0], vv[1], vv[2], vv[3]}; *(LAS u32x4*)(Vt + d * P64 + 16 * seg + 8) = (u32x4){vv[4], vv[5], vv[6], vv[7]};
    }
    __syncthreads();
    const int wid = F.wave, lane = F.lane, wr = wid >> 2, wc = wid & 3, fr = lane & 15, fq = lane >> 4;
    {
        f32x4 aa[2] = {(f32x4){0.f, 0.f, 0.f, 0.f}, (f32x4){0.f, 0.f, 0.f, 0.f}};
#pragma unroll
        for (int ks = 0; ks < 4; ++ks) {
            const bf16x8 bfr = *(const LAS bf16x8*)(KD + (16 * wc + fr) * P128 + 32 * ks + 8 * fq);
#pragma unroll
            for (int m = 0; m < 2; ++m) { const bf16x8 af = *(const LAS bf16x8*)(QD + (32 * wr + 16 * m + fr) * P128 + 32 * ks + 8 * fq); aa[m] = __builtin_amdgcn_mfma_f32_16x16x32_bf16(bfr, af, aa[m], 0, 0, 0); }
        }
#pragma unroll
        for (int m = 0; m < 2; ++m) { const int t = 32 * wr + 16 * m + fr, s0 = 16 * wc + 4 * fq; float v[4];
#pragma unroll
            for (int j = 0; j < 4; ++j) v[j] = (s0 + j <= t) ? aa[m][j] : 0.f;
            u32x2 o; o.x = cvt_pk_bf16(v[0], v[1]); o.y = cvt_pk_bf16(v[2], v[3]); *(LAS u32x2*)(ATT + t * P64 + s0) = o; }
    }
    __syncthreads();
    f32x4 acc[2][2];
#pragma unroll
    for (int m = 0; m < 2; ++m)
#pragma unroll
        for (int nn = 0; nn < 2; ++nn) acc[m][nn] = (f32x4){0.f, 0.f, 0.f, 0.f};
#pragma unroll
    for (int ks = 0; ks < 2; ++ks) {
        bf16x8 af[2], bfr[2];
#pragma unroll
        for (int m = 0; m < 2; ++m) af[m] = *(const LAS bf16x8*)(ATT + (32 * wr + 16 * m + fr) * P64 + 32 * ks + 8 * fq);
#pragma unroll
        for (int nn = 0; nn < 2; ++nn) bfr[nn] = *(const LAS bf16x8*)(Vt + (32 * wc + 16 * nn + fr) * P64 + 32 * ks + 8 * fq);
#pragma unroll
        for (int m = 0; m < 2; ++m)
#pragma unroll
            for (int nn = 0; nn < 2; ++nn) acc[m][nn] = __builtin_amdgcn_mfma_f32_16x16x32_bf16(bfr[nn], af[m], acc[m][nn], 0, 0, 0);
    }
#pragma unroll
    for (int ks = 0; ks < 4; ++ks) {
        bf16x8 af[2], bfr[2];
#pragma unroll
        for (int m = 0; m < 2; ++m) af[m] = *(const LAS bf16x8*)(QD + (32 * wr + 16 * m + fr) * P128 + 32 * ks + 8 * fq);
#pragma unroll
        for (int nn = 0; nn < 2; ++nn) bfr[nn] = *(const LAS bf16x8*)(SPt + (32 * wc + 16 * nn + fr) * P128 + 32 * ks + 8 * fq);
#pragma unroll
        for (int m = 0; m < 2; ++m)
#pragma unroll
            for (int nn = 0; nn < 2; ++nn) acc[m][nn] = __builtin_amdgcn_mfma_f32_16x16x32_bf16(bfr[nn], af[m], acc[m][nn], 0, 0, 0);
    }
#pragma unroll
    for (int m = 0; m < 2; ++m) { float q = 0.f;
#pragma unroll
        for (int nn = 0; nn < 2; ++nn) q += (acc[m][nn][0] * acc[m][nn][0] + acc[m][nn][1] * acc[m][nn][1]) + (acc[m][nn][2] * acc[m][nn][2] + acc[m][nn][3] * acc[m][nn][3]);
        q += __shfl_xor(q, 16); q += __shfl_xor(q, 32);
        if (fq == 0) SS[(32 * wr + 16 * m + fr) * 4 + wc] = q; }
    __syncthreads();
#pragma unroll
    for (int m = 0; m < 2; ++m) { const int t = 32 * wr + 16 * m + fr; const f32x4 ss = *(const LAS f32x4*)(SS + t * 4);
        const float r = rsqrtf(((ss[0] + ss[1]) + (ss[2] + ss[3])) * (1.f / 128.f) + LN_EPS);
#pragma unroll
        for (int nn = 0; nn < 2; ++nn) { const int e = 32 * wc + 16 * nn + 4 * fq; const size_t off = (size_t)(r0 + t) * 2048 + c0 + e;
            const f32x4 g4 = *(const f32x4*)(gn + c0 + e); const u32x2 sg = *(const u32x2*)(SG + off);
            u32x2 o; o.x = cvt_pk_bf16(acc[m][nn][0] * r * g4[0] * bflo(sg.x), acc[m][nn][1] * r * g4[1] * bfhi(sg.x)); o.y = cvt_pk_bf16(acc[m][nn][2] * r * g4[2] * bflo(sg.y), acc[m][nn][3] * r * g4[3] * bfhi(sg.y));
            *(u32x2*)(YB + off) = o; } }
    __syncthreads();
}

constexpr int N_PHASES = 20;
__global__ void __launch_bounds__(NTHREADS, 2) mk_fwd(Args args) {
    extern __shared__ __attribute__((aligned(16))) unsigned char lds[];
    Frame F;
    F.lds = (LAS unsigned char*)lds;
    F.tid = threadIdx.x; F.lane = F.tid & 63; F.wave = __builtin_amdgcn_readfirstlane(F.tid >> 6);
    F.G = gridDim.x; { const int bx = blockIdx.x; F.vcu = (F.G % 8 == 0) ? (bx % 8) * (F.G / 8) + bx / 8 : bx; }
    F.ws = args.ws;
    unsigned char* ws = args.ws;
    volatile LAS unsigned* MISC = (volatile LAS unsigned*)(F.lds + MISC_OFF);
    for (int u = F.tid; u < (LDS_BYTES - LDSCTL_OFF) / 4; u += NTHREADS) ((LAS unsigned*)(F.lds + LDSCTL_OFF))[u] = 0u;
    __syncthreads();
    XcdBarrier bar; bar.bar = (unsigned*)(ws + WS_CTL) + 4096; bar.x = 0; bar.st = nullptr;
    const bool one_launch = (args.ph_hi - args.ph_lo) > 1;
    if (one_launch) bar = xcd_barrier_post((unsigned*)(ws + WS_CTL) + 4096, MISC + 8);
    const int lo = args.ph_lo, hi = args.ph_hi;
#define IN(k) (lo <= (k) && (k) < hi)
#define SEAM(k) do { if (IN(k) && IN((k) + 1)) xcd_barrier(bar); } while (0)

    bf16_t* XN = (bf16_t*)(ws + WS_XN); float* XF = (float*)(ws + WS_XF);
    bf16_t* HB = (bf16_t*)(ws + WS_HB); bf16_t* GB = (bf16_t*)(ws + WS_GB);
    bf16_t* ZA = (bf16_t*)(ws + WS_ZA); bf16_t* XB = (bf16_t*)(ws + WS_XB); bf16_t* PB = (bf16_t*)(ws + WS_PB); bf16_t* CAT = (bf16_t*)(ws + WS_CAT); f32x2* STAT = (f32x2*)(ws + WS_STAT);
    bf16_t* QB = (bf16_t*)(ws + WS_QB); float* FL = (float*)(ws + WS_FL); bf16_t* VB = (bf16_t*)(ws + WS_VB); bf16_t* SG = (bf16_t*)(ws + WS_SG);
    bf16_t* UPD = (bf16_t*)(ws + WS_UPD); float* DEC = (float*)(ws + WS_DEC); bf16_t* YB = (bf16_t*)(ws + WS_YB);
    LAS unsigned char* ring = F.lds;

    if (IN(0)) { p0_prologue(F, args); } SEAM(0);
    if (IN(1)) { pg8::Gemm g{XN, (const bf16_t*)(ws + WS_WIN0), D, D, D, 0}; pg8::StaticOrder S; S.init(M, NIN0, F.G, (int)blockIdx.x);
        pg8::EpiIn0 E{ZA, XB, STAT}; pg8::gemm_phase<pg8::EpiIn0, pg8::StaticOrder, true>(ring, g, S, E); } SEAM(1);
    if (IN(2)) { for (int u = F.vcu; u < 512; u += F.G) mixer_a_unit(F, u, ZA, STAT, args.in[4], args.in[5], args.in[2], args.in[3], CAT);
        pool_items(F, XB, PB); } SEAM(2);
    if (IN(3)) { pg8::Gemm g{PB, (const bf16_t*)(ws + WS_WPOOL), 1024, 256, 256, 256}; pg8::StaticOrder S; S.init(M, DB, F.G, (int)blockIdx.x);
        pg8::EpiBf16 E{CAT, 2048, 1024, args.in[7]}; pg8::gemm_phase<pg8::EpiBf16, pg8::StaticOrder, true>(ring, g, S, E); } SEAM(3);
    if (IN(4)) { pg8::Gemm g{CAT, (const bf16_t*)(ws + WS_WOUT0), D, D, D, 0}; pg8::StaticOrder S; S.init(M, D, F.G, (int)blockIdx.x);
        pg8::EpiRes E{args.in[0], XF}; pg8::gemm_phase<pg8::EpiRes, pg8::StaticOrder, true>(ring, g, S, E); } SEAM(4);
    if (IN(5)) { ln_phase(F, XF, XF, XN, args.in[17], args.in[18]); } SEAM(5);
    if (IN(6)) { pg8::Gemm g{XN, (const bf16_t*)(ws + WS_WUP), D, D, D, 0}; pg8::StaticOrder S; S.init(M, NUP, F.G, (int)blockIdx.x);
        pg8::EpiBf16 E{HB, NUP, 0, nullptr}; pg8::gemm_phase<pg8::EpiBf16, pg8::StaticOrder, true>(ring, g, S, E); } SEAM(6);
    if (IN(7)) { conv_phase(F, HB, args.in[14], args.in[15], GB); } SEAM(7);
    if (IN(8)) { pg8::Gemm g{GB, (const bf16_t*)(ws + WS_WDOWN), DFF, DFF, DFF, 0}; pg8::StaticOrder S; S.init(M, D, F.G, (int)blockIdx.x);
        pg8::EpiRes E{XF, XF}; pg8::gemm_phase<pg8::EpiRes, pg8::StaticOrder, true>(ring, g, S, E); } SEAM(8);
    if (IN(9)) { ln_phase(F, XF, XF, XN, args.in[19], args.in[20]); } SEAM(9);
    if (IN(10)) { pg8::Gemm g{XN, (const bf16_t*)(ws + WS_WIN1), D, D, D, 0}; pg8::StaticOrder S; S.init(M, NIN1, F.G, (int)blockIdx.x);
        pg8::EpiIn1 E{ws + WS_QB}; pg8::gemm_phase<pg8::EpiIn1, pg8::StaticOrder, true>(ring, g, S, E); } SEAM(10);
    if (IN(11)) { for (int u = F.vcu; u < 2048; u += F.G) h1_unit(F, u, FL, VB, args.in[12], UPD, DEC); } SEAM(11);
    if (IN(12)) { h2_scan(F, UPD, DEC); } SEAM(12);
    if (IN(13)) { for (int u = F.vcu; u < 2048; u += F.G) h3_unit(F, u, QB, FL, VB, SG, args.in[12], UPD, args.in[10], YB); } SEAM(13);
    if (IN(14)) { pg8::Gemm g{YB, (const bf16_t*)(ws + WS_WOUT1), D, D, D, 0}; pg8::StaticOrder S; S.init(M, D, F.G, (int)blockIdx.x);
        pg8::EpiRes E{XF, XF}; pg8::gemm_phase<pg8::EpiRes, pg8::StaticOrder, true>(ring, g, S, E); } SEAM(14);
    if (IN(15)) { ln_phase(F, XF, XF, XN, args.in[17] + D, args.in[18] + D); } SEAM(15);
    if (IN(16)) { pg8::Gemm g{XN, (const bf16_t*)(ws + WS_WUP) + (size_t)D * NUP, D, D, D, 0}; pg8::StaticOrder S; S.init(M, NUP, F.G, (int)blockIdx.x);
        pg8::EpiBf16 E{HB, NUP, 0, nullptr}; pg8::gemm_phase<pg8::EpiBf16, pg8::StaticOrder, true>(ring, g, S, E); } SEAM(16);
    if (IN(17)) { conv_phase(F, HB, args.in[14] + 3 * NUP, args.in[15] + NUP, GB); } SEAM(17);
    if (IN(18)) { pg8::Gemm g{GB, (const bf16_t*)(ws + WS_WDOWN) + (size_t)DFF * D, DFF, DFF, DFF, 0}; pg8::StaticOrder S; S.init(M, D, F.G, (int)blockIdx.x);
        pg8::EpiRes E{XF, XF}; pg8::gemm_phase<pg8::EpiRes, pg8::StaticOrder, true>(ring, g, S, E); } SEAM(18);
    if (IN(19)) { ln_phase(F, XF, args.out, nullptr, args.in[19] + D, args.in[20] + D); }
#undef IN
#undef SEAM
}

extern "C" void kernel_launch(void* const* d_in, const int* in_sizes, int n_in, void* d_out, int out_size, void* d_ws, size_t ws_size, hipStream_t stream) {
    static int grid = 0;
    if (grid == 0) {
        if (n_in != 21 || ws_size < WS_END) { fprintf(stderr, "kernel_launch: unexpected inputs (n_in %d, ws %zu)\n", n_in, ws_size); grid = -1; return; }
        int dev = 0, cus = 0;
        if (hipGetDevice(&dev) != hipSuccess || hipDeviceGetAttribute(&cus, hipDeviceAttributeMultiprocessorCount, dev) != hipSuccess) { grid = -1; return; }
        if (hipFuncSetAttribute((const void*)mk_fwd, hipFuncAttributeMaxDynamicSharedMemorySize, LDS_BYTES) != hipSuccess) { fprintf(stderr, "kernel_launch: hipFuncSetAttribute failed\n"); grid = -1; return; }
        int per_cu = 0;
        if (hipOccupancyMaxActiveBlocksPerMultiprocessor(&per_cu, (const void*)mk_fwd, NTHREADS, LDS_BYTES) != hipSuccess || per_cu < 1) fprintf(stderr, "kernel_launch: occupancy query says %d\n", per_cu);
        (void)hipGetLastError();
        grid = cus;
    }
    if (grid < 0) return;
    (void)hipMemsetAsync((char*)d_ws + WS_CTL, 0, CTL_ZERO_BYTES, stream);
    Args a{};
    for (int i = 0; i < 21; ++i) a.in[i] = (const float*)d_in[i];
    a.out = (float*)d_out; a.ws = (unsigned char*)d_ws;
#if MK_N_LAUNCHES == 1
    a.ph_lo = 0; a.ph_hi = N_PHASES;
    hipLaunchKernelGGL(mk_fwd, dim3(grid), dim3(NTHREADS), LDS_BYTES, stream, a);
#else
    for (int p = 0; p < N_PHASES; ++p) { a.ph_lo = p; a.ph_hi = p + 1; hipLaunchKernelGGL(mk_fwd, dim3(grid), dim3(NTHREADS), LDS_BYTES, stream, a); }
#endif
}
```
